# Optimizing an MI355X kernel written in HIP

```python
import math
import jax, jax.numpy as jnp
from jax import lax
import numpy as np

D_MODEL = 1024
BATCH = 8
SEQ = 2048
DEPTH = 1
DEC_BATCH = 16
DEC_SEQ = 4096
PAST_LEN = 128

ATT_GROUPS = ((128, 1), (512, 4), (2048, 16))
ATT_HEADS_PER_GROUP = 4
ATT_HEAD_DIM = 64
ATT_N_GROUPS = 3
ATT_BLOCK = 64
ATT_QK = ATT_N_GROUPS * ATT_HEADS_PER_GROUP * ATT_HEAD_DIM
ATT_OUT = ATT_HEADS_PER_GROUP * ATT_HEAD_DIM
ROT_DIM = ATT_HEAD_DIM // 4
ROPE_THETA = 500000.0
M_INNER = 2 * D_MODEL
M_HEAD_DIM = 64
M_HEADS = M_INNER // M_HEAD_DIM
M_GROUPS = 4
M_STATE = 64
M_CONV = 3
M_CHUNK = 64
M_XBC = M_INNER + 2 * M_GROUPS * M_STATE
FFN_DIM = 2 * D_MODEL
FFN_CONV = 3
PLE_DIM = 256
EPS = 1e-6
NEG = -1e30

IN_SIZES = (ATT_QK, ATT_QK, ATT_QK, M_INNER, M_XBC, 2 * M_HEADS, 2 * D_MODEL)
IN_COLS = sum(IN_SIZES)
IN_SPLITS = tuple(sum(IN_SIZES[:i + 1]) for i in range(len(IN_SIZES) - 1))

kernel_name = "hybrid_dilated_attn_ssd_encoder"


def rmsnorm(x, g):
    xf = x.astype(jnp.float32)
    y = xf * lax.rsqrt(jnp.mean(xf * xf, axis=-1, keepdims=True) + EPS)
    return (y * g.astype(jnp.float32)).astype(x.dtype)


def centred_dwconv(x, w, b):
    K = w.shape[0]
    r = K // 2
    S = x.shape[1]
    xp = jnp.pad(x, ((0, 0), (r, r), (0, 0)))
    y = xp[:, 0:S] * w[0]
    for kk in range(1, K):
        y = y + xp[:, kk:kk + S] * w[kk]
    return y + b


def partial_rope(x, pos):
    half = ROT_DIM // 2
    inv = jnp.exp(-math.log(ROPE_THETA) * jnp.arange(half, dtype=jnp.float32) * (2.0 / ROT_DIM))
    ang = pos.astype(jnp.float32)[:, None] * inv[None, :]
    cos = jnp.cos(ang)[None, :, None, :]
    sin = jnp.sin(ang)[None, :, None, :]
    xr = x[..., :ROT_DIM].astype(jnp.float32)
    x1, x2 = xr[..., :half], xr[..., half:]
    rot = jnp.concatenate([x1 * cos - x2 * sin, x2 * cos + x1 * sin], axis=-1).astype(x.dtype)
    return jnp.concatenate([rot, x[..., ROT_DIM:]], axis=-1)


def band_attention(q, k, v, nb):
    N, L, H, Dh = q.shape
    blk = ATT_BLOCK
    nq = -(-L // blk)
    Lp = nq * blk
    qb = jnp.pad(q, ((0, 0), (0, Lp - L), (0, 0), (0, 0))).reshape(N, nq, blk, H, Dh)
    def kv_blocks(t):
        t = jnp.pad(t, ((0, 0), (blk, Lp - L + blk), (0, 0), (0, 0))).reshape(N, nq + 2, blk, H, Dh)
        return jnp.concatenate([t[:, :-2], t[:, 1:-1], t[:, 2:]], axis=2)
    kw, vw = kv_blocks(k), kv_blocks(v)
    qi = jnp.arange(nq)[:, None, None] * blk + jnp.arange(blk)[None, :, None]
    kj = jnp.arange(nq)[:, None, None] * blk - blk + jnp.arange(3 * blk)[None, None, :]
    mask = (jnp.abs(qi - kj) <= nb) & (kj >= 0) & (kj < L)
    s = jnp.einsum('nqahd,nqbhd->nqhab', qb.astype(jnp.float32), kw.astype(jnp.float32)) * (Dh ** -0.5)
    s = jnp.where(mask[None, :, None], s, NEG)
    lse = jax.nn.logsumexp(s, axis=-1)
    pr = jnp.exp(s - lse[..., None])
    o = jnp.einsum('nqhab,nqbhd->nqahd', pr, vw.astype(jnp.float32)).reshape(N, Lp, H, Dh)[:, :L]
    lse = lse.transpose(0, 1, 3, 2).reshape(N, Lp, H)[:, :L]
    return o, lse


def dilated_attention(q, k, v, window, dil):
    B, S, H, Dh = q.shape
    L = S // dil
    def to_sub(t):
        return t.reshape(B, L, dil, H, Dh).transpose(0, 2, 1, 3, 4).reshape(B * dil, L, H, Dh)
    o, lse = band_attention(to_sub(q), to_sub(k), to_sub(v), window // (2 * dil))
    o = o.reshape(B, dil, L, H, Dh).transpose(0, 2, 1, 3, 4).reshape(B, S, H, Dh)
    lse = lse.reshape(B, dil, L, H).transpose(0, 2, 1, 3).reshape(B, S, H)
    return o, lse


def ssd_scan(x, dt, a, bm, cm):
    Bn, S, H, P = x.shape
    G, N = bm.shape[2], bm.shape[3]
    K = H // G
    T = M_CHUNK
    C = S // T
    f32 = jnp.float32
    dtf = dt.astype(f32)
    xd = (x.astype(f32) * dtf[..., None]).reshape(Bn, C, T, G, K, P)
    acs = jnp.cumsum((dtf * a.astype(f32)).reshape(Bn, C, T, G, K), axis=2).transpose(0, 1, 3, 4, 2)
    bc = bm.astype(f32).reshape(Bn, C, T, G, N)
    cc = cm.astype(f32).reshape(Bn, C, T, G, N)
    tri = jnp.tril(jnp.ones((T, T), dtype=bool))
    seg = acs[..., :, None] - acs[..., None, :]
    lmat = jnp.where(tri, jnp.exp(jnp.where(tri, seg, 0.0)), 0.0)
    cb = jnp.einsum('bctgn,bcsgn->bcgts', cc, bc)
    y_diag = jnp.einsum('bcgkts,bcsgkp->bctgkp', cb[:, :, :, None] * lmat, xd)
    decay_s = jnp.exp(acs[..., -1:] - acs)
    states = jnp.einsum('bctgn,bcgkt,bctgkp->bcgkpn', bc, decay_s, xd)
    chunk_decay = jnp.exp(acs[..., -1])
    def step(hs, inp):
        st, dec = inp
        return hs * dec[..., None, None] + st, hs
    h0 = jnp.zeros((Bn, G, K, P, N), f32)
    _, prev = lax.scan(step, h0, (states.transpose(1, 0, 2, 3, 4, 5), chunk_decay.transpose(1, 0, 2, 3)))
    prev = prev.transpose(1, 0, 2, 3, 4, 5)
    y_off = jnp.einsum('bctgn,bcgkpn,bcgkt->bctgkp', cc, prev, jnp.exp(acs))
    return (y_diag + y_off).reshape(Bn, S, H, P)


def encoder_layer(h, pl, lp):
    B, S, _ = h.shape
    dtype = h.dtype
    xn = rmsnorm(h, lp['norm_mix_pre'])
    proj = xn @ lp['w_in']
    q, k, v, z, xbc, dt_raw, gates = jnp.split(proj, IN_SPLITS, axis=-1)

    Hg, Dh = ATT_HEADS_PER_GROUP, ATT_HEAD_DIM
    pos = jnp.arange(S)
    q = partial_rope(q.reshape(B, S, ATT_N_GROUPS * Hg, Dh), pos)
    k = partial_rope(k.reshape(B, S, ATT_N_GROUPS * Hg, Dh), pos)
    v = v.reshape(B, S, ATT_N_GROUPS * Hg, Dh)
    outs, lses = [], []
    for gi, (win, dil) in enumerate(ATT_GROUPS):
        sl = slice(gi * Hg, (gi + 1) * Hg)
        o, l = dilated_attention(q[:, :, sl], k[:, :, sl], v[:, :, sl], win, dil)
        outs.append(o)
        lses.append(l)
    wts = jax.nn.softmax(jnp.stack(lses), axis=0)
    att = jnp.sum(wts[..., None] * jnp.stack(outs), axis=0).reshape(B, S, ATT_OUT).astype(dtype)
    a_branch = att @ lp['w_attn_branch']

    xbc = jax.nn.silu(centred_dwconv(xbc, lp['mamba_conv_w'], lp['mamba_conv_b']))
    xm, bm, cm = jnp.split(xbc, (M_INNER, M_INNER + M_GROUPS * M_STATE), axis=-1)
    xm = xm.reshape(B, S, M_HEADS, M_HEAD_DIM)
    bm = bm.reshape(B, S, M_GROUPS, M_STATE)
    cm = cm.reshape(B, S, M_GROUPS, M_STATE)
    dt = jax.nn.softplus(dt_raw.astype(jnp.float32).reshape(B, S, 2, M_HEADS)
                         + lp['dt_bias'].astype(jnp.float32))
    a = -jnp.exp(lp['a_log'].astype(jnp.float32))
    y_f = ssd_scan(xm, dt[:, :, 0], a[0], bm, cm)
    flip = lambda t: t[:, ::-1]
    y_b = flip(ssd_scan(flip(xm), flip(dt[:, :, 1]), a[1], flip(bm), flip(cm)))
    y = y_f + y_b + lp['d_skip'].astype(jnp.float32)[:, None] * xm.astype(jnp.float32)
    y = y.reshape(B, S, M_INNER) * jax.nn.silu(z.astype(jnp.float32))
    yg = y.reshape(B, S, M_GROUPS, M_INNER // M_GROUPS)
    yg = yg * lax.rsqrt(jnp.mean(yg * yg, axis=-1, keepdims=True) + EPS)
    y = (yg.reshape(B, S, M_INNER) * lp['mamba_norm'].astype(jnp.float32)).astype(dtype)
    m_branch = y @ lp['w_mamba_branch']

    g = jax.nn.sigmoid(gates.reshape(B, S, 2, D_MODEL))
    mix = (g[:, :, 0] * a_branch + g[:, :, 1] * m_branch) @ lp['w_out']
    h = h + rmsnorm(mix, lp['norm_mix_post'])

    u = rmsnorm(h, lp['norm_ffn_pre']) @ lp['w_ffn_up']
    u = centred_dwconv(u, lp['ffn_conv_w'], lp['ffn_conv_b'])
    ug, uv = jnp.split(u, 2, axis=-1)
    f = (jax.nn.gelu(ug, approximate=True) * uv) @ lp['w_ffn_down']
    h = h + rmsnorm(f, lp['norm_ffn_post'])

    e = pl @ lp['w_ple_proj']
    pg = jax.nn.sigmoid(h @ lp['w_ple_gate'])
    h = h + rmsnorm(pg * e, lp['norm_ple'])
    return h


def setup_inputs(seed: int = 0) -> dict:
    key = jax.random.key(seed)
    ks = jax.random.split(key, 32)
    f32 = jnp.float32
    nrm = lambda kk, shape, scale: jax.random.normal(kk, shape, f32) * scale
    gain = lambda kk, shape: 1.0 + 0.05 * jax.random.normal(kk, shape, f32)
    L = DEPTH
    dt0 = jnp.exp(jax.random.uniform(ks[10], (L, 2, M_HEADS), f32, math.log(1e-3), math.log(1e-1)))
    dt_bias = dt0 + jnp.log(-jnp.expm1(-dt0))
    return {
        'x_prompt': nrm(ks[0], (BATCH, SEQ, D_MODEL), 1.0),
        'x_sample': nrm(ks[1], (DEC_BATCH, DEC_SEQ, D_MODEL), 1.0),
        'p_prompt': nrm(ks[2], (DEPTH, BATCH, SEQ, PLE_DIM), 1.0),
        'p_sample': nrm(ks[3], (DEPTH, DEC_BATCH, DEC_SEQ, PLE_DIM), 1.0),
        'norm_mix_pre': gain(ks[4], (L, D_MODEL)),
        'norm_mix_post': gain(ks[5], (L, D_MODEL)),
        'w_in': nrm(ks[6], (L, D_MODEL, IN_COLS), D_MODEL ** -0.5),
        'mamba_conv_w': nrm(ks[7], (L, M_CONV, M_XBC), M_CONV ** -0.5),
        'mamba_conv_b': nrm(ks[8], (L, M_XBC), 0.01),
        'a_log': jnp.log(jax.random.uniform(ks[9], (L, 2, M_HEADS), f32, 1.0, 16.0)),
        'dt_bias': dt_bias,
        'd_skip': gain(ks[11], (L, M_HEADS)),
        'mamba_norm': gain(ks[12], (L, M_INNER)),
        'w_attn_branch': nrm(ks[13], (L, ATT_OUT, D_MODEL), ATT_OUT ** -0.5),
        'w_mamba_branch': nrm(ks[14], (L, M_INNER, D_MODEL), M_INNER ** -0.5),
        'w_out': nrm(ks[15], (L, D_MODEL, D_MODEL), D_MODEL ** -0.5),
        'norm_ffn_pre': gain(ks[16], (L, D_MODEL)),
        'w_ffn_up': nrm(ks[17], (L, D_MODEL, 2 * FFN_DIM), D_MODEL ** -0.5),
        'ffn_conv_w': nrm(ks[18], (L, FFN_CONV, 2 * FFN_DIM), FFN_CONV ** -0.5),
        'ffn_conv_b': nrm(ks[19], (L, 2 * FFN_DIM), 0.01),
        'w_ffn_down': nrm(ks[20], (L, FFN_DIM, D_MODEL), FFN_DIM ** -0.5),
        'norm_ffn_post': gain(ks[21], (L, D_MODEL)),
        'w_ple_proj': nrm(ks[22], (L, PLE_DIM, D_MODEL), PLE_DIM ** -0.5),
        'w_ple_gate': nrm(ks[23], (L, D_MODEL, D_MODEL), D_MODEL ** -0.5),
        'norm_ple': gain(ks[24], (L, D_MODEL)),
    }


def reference(x_prompt, x_sample, p_prompt, p_sample, norm_mix_pre, norm_mix_post, w_in,
              mamba_conv_w, mamba_conv_b, a_log, dt_bias, d_skip, mamba_norm, w_attn_branch,
              w_mamba_branch, w_out, norm_ffn_pre, w_ffn_up, ffn_conv_w, ffn_conv_b, w_ffn_down,
              norm_ffn_post, w_ple_proj, w_ple_gate, norm_ple):
    def layer_params(i):
        return {
            'norm_mix_pre': norm_mix_pre[i], 'norm_mix_post': norm_mix_post[i], 'w_in': w_in[i],
            'mamba_conv_w': mamba_conv_w[i], 'mamba_conv_b': mamba_conv_b[i], 'a_log': a_log[i],
            'dt_bias': dt_bias[i], 'd_skip': d_skip[i], 'mamba_norm': mamba_norm[i],
            'w_attn_branch': w_attn_branch[i], 'w_mamba_branch': w_mamba_branch[i], 'w_out': w_out[i],
            'norm_ffn_pre': norm_ffn_pre[i], 'w_ffn_up': w_ffn_up[i], 'ffn_conv_w': ffn_conv_w[i],
            'ffn_conv_b': ffn_conv_b[i], 'w_ffn_down': w_ffn_down[i], 'norm_ffn_post': norm_ffn_post[i],
            'w_ple_proj': w_ple_proj[i], 'w_ple_gate': w_ple_gate[i], 'norm_ple': norm_ple[i],
        }
    h_p = x_prompt
    h_s = x_sample
    for i in range(DEPTH):
        lp = layer_params(i)
        h_p = encoder_layer(h_p, p_prompt[i], lp)
        h_s = encoder_layer(h_s, p_sample[i], lp)
    y_prompt = h_p
    y_sample = h_s
    return (y_prompt, y_sample)
```

```cpp
#include <hip/hip_runtime.h>
#include <hip/hip_cooperative_groups.h>
#include <cstdio>
#include <cstdint>
namespace cg = cooperative_groups;

#define LAS __attribute__((address_space(3)))
typedef unsigned short bf16_t;
typedef short bf16x8 __attribute__((ext_vector_type(8)));
typedef float f32x4 __attribute__((ext_vector_type(4)));
typedef unsigned u32x4 __attribute__((ext_vector_type(4)));
typedef unsigned u32x2 __attribute__((ext_vector_type(2)));

constexpr int DM = 1024, NPROMPT = 16384, NTOK = 81920;
constexpr int MAXR = 28672;
constexpr int N1 = 9216;
constexpr int LD_QKV = 2304, LD_Z = 2048, LD_XBC = 2560, LD_G = 2048, LD_DT = 64;
constexpr float EPS = 1e-6f;
constexpr int NTHR = 512, NWAVE = 8;
constexpr int LDS_BYTES = 135168;

constexpr size_t MiB = 1u << 20;
constexpr size_t OFF_ROPE = 0;
constexpr size_t OFF_W1 = 1 * MiB, OFF_WA = 20 * MiB, OFF_WM = 21 * MiB, OFF_WO = 25 * MiB, OFF_WUP = 27 * MiB,
                 OFF_WDN = 35 * MiB, OFF_WP = 39 * MiB, OFF_WG = 40 * MiB, OFF_ACT = 48 * MiB;
constexpr size_t OFF_XS = OFF_ACT;
constexpr size_t OFF_QKV = OFF_XS + (size_t)MAXR * 2048;
constexpr size_t OFF_Z = OFF_QKV + (size_t)MAXR * 4608;
constexpr size_t OFF_XBC = OFF_Z + (size_t)MAXR * 4096;
constexpr size_t OFF_GATES = OFF_XBC + (size_t)MAXR * 5120;
constexpr size_t OFF_DT = OFF_GATES + (size_t)MAXR * 4096;
constexpr size_t OFF_XBCC = OFF_DT + (size_t)MAXR * 128;
constexpr size_t OFF_DTF = OFF_XBCC + (size_t)MAXR * 5120;
constexpr size_t OFF_LSE = OFF_DTF + (size_t)MAXR * 256;
constexpr size_t OFF_ATT = OFF_LSE + (size_t)MAXR * 64;
constexpr size_t OFF_SSQ = OFF_ATT + (size_t)MAXR * 512;
constexpr size_t WS_END = OFF_SSQ + (size_t)MAXR * 256;

struct Params {
    const float* in[25];
    float* out;
    unsigned char* ws;
    int npass; int pad;
    int prow0[4]; int pnrows[4];
};

__device__ __forceinline__ unsigned cvt_pk_bf16(float lo, float hi) { unsigned r; asm volatile("v_cvt_pk_bf16_f32 %0, %1, %2" : "=v"(r) : "v"(lo), "v"(hi)); return r; }
__device__ __forceinline__ float bf_lo(unsigned u) { return __uint_as_float(u << 16); }
__device__ __forceinline__ float bf_hi(unsigned u) { return __uint_as_float(u & 0xffff0000u); }
__device__ __forceinline__ float sigmoidf_(float x) { return 1.f / (1.f + __expf(-x)); }
__device__ __forceinline__ int tid_() { int t = threadIdx.x; asm volatile("" : "+v"(t)); return t; }
__device__ __forceinline__ int bid_() { int t = blockIdx.x; asm volatile("" : "+s"(t)); return t; }
__device__ __forceinline__ float wave_sum(float v) {
#pragma unroll
    for (int o = 1; o < 64; o <<= 1) v += __shfl_xor(v, o);
    return v;
}
__device__ __forceinline__ void unpack8(const u32x4 w, float (&f)[8]) {
    f[0] = bf_lo(w.x); f[1] = bf_hi(w.x); f[2] = bf_lo(w.y); f[3] = bf_hi(w.y);
    f[4] = bf_lo(w.z); f[5] = bf_hi(w.z); f[6] = bf_lo(w.w); f[7] = bf_hi(w.w);
}
__device__ __forceinline__ u32x4 pack8(const float (&f)[8]) {
    u32x4 w; w.x = cvt_pk_bf16(f[0], f[1]); w.y = cvt_pk_bf16(f[2], f[3]); w.z = cvt_pk_bf16(f[4], f[5]); w.w = cvt_pk_bf16(f[6], f[7]); return w;
}
__device__ __forceinline__ int seq_pos(int grow) { return grow < NPROMPT ? (grow & 2047) : (grow & 4095); }
__device__ __forceinline__ int seq_len(int grow) { return grow < NPROMPT ? 2048 : 4096; }

namespace pg8 {
constexpr int BM = 256, BK = 64, HALF = 128, HTB = HALF * BK * 2, STAGE_BYTES = 8 * HTB, NXCD = 8, WGM = 8;
__host__ __device__ __forceinline__ int lds_byte(int r, int c) { const int st = (r >> 4) * 2 + (c >> 5), rr = r & 15, cc = c & 31, ob = rr * 64 + cc * 2; return st * 1024 + (ob ^ (((ob >> 9) & 1) << 5)); }
__host__ __device__ __forceinline__ void stage_rc(int b, int& R, int& C) { const int st = b / 1024, sb = b % 1024, swz = sb ^ (((sb >> 9) & 1) << 5); R = (st >> 1) * 16 + swz / 64; C = (st & 1) * 32 + (swz % 64) / 2; }
__host__ __device__ __forceinline__ int perm32(int rho) { const int n = rho >> 4, i = rho & 15; return 8 * (i >> 2) + 4 * n + (i & 3); }
struct Unit { int pm, pn; };
struct Gemm { const bf16_t* A; const bf16_t* Bt; int M, N, K, lda, ldb; };
struct StaticOrder {
    int nM, nN, nwg, G, c;
    __device__ void init(int M, int N, int G_, int c_) { nM = M / BM; nN = N / BM; nwg = nM * nN; G = G_; c = c_; }
    __device__ bool next(int i, Unit& u) const {
        const long L = (long)i * G + c; if (L >= nwg) return false;
        int wgid = (int)L; { const int q = nwg / NXCD, r = nwg % NXCD, xcd = wgid % NXCD, off = wgid / NXCD; wgid = (xcd < r ? xcd * (q + 1) : r * (q + 1) + (xcd - r) * q) + off; }
        const int nig = WGM * nN, gid = wgid / nig, fm = gid * WGM, gsz = (nM - fm) < WGM ? (nM - fm) : WGM;
        u.pm = __builtin_amdgcn_readfirstlane(fm + ((wgid % nig) % gsz)); u.pn = __builtin_amdgcn_readfirstlane((wgid % nig) / gsz); return true;
    }
};
template <class Epi>
__device__ __forceinline__ void gemm_phase(LAS unsigned char* lds, const Gemm g, const StaticOrder& S, const Epi& E) {
    const int tid = tid_(), wid = __builtin_amdgcn_readfirstlane(tid >> 6), lane = tid & 63, wr = wid >> 2, wc = wid & 3, fr = lane & 15, fq = lane >> 4;
    const int K = g.K, nt = K / BK;
    unsigned voffA[2], voffB[2];
#pragma unroll
    for (int i = 0; i < 2; ++i) { int R, C; stage_rc(tid * 16 + i * 8192, R, C); const int Rb = (R & ~31) + perm32(R & 31);
        voffA[i] = (unsigned)(R * g.lda + C) * 2u; voffB[i] = (unsigned)(Rb * g.ldb + C) * 2u; }
    const size_t kstep = (size_t)(BK * 2);
    const size_t hstepA = (size_t)HALF * g.lda * 2, hstepB = (size_t)HALF * g.ldb * 2;
    const size_t tstepA = 2 * hstepA, tstepB = 2 * hstepB;
    const unsigned ldsw = (unsigned)wid * 1024u;
    const int aoff = lds_byte(wr * 64 + fr, fq * 8), boff = lds_byte(wc * 32 + fr, fq * 8);
#define PG8_SA(b, h) (((b) * 2 + (h)) * HTB)
#define PG8_SB(b, h) ((4 + (b) * 2 + (h)) * HTB)
#define PG8_STAGE(bufoff, gbase, voff) do { _Pragma("unroll") for (int _i = 0; _i < 2; ++_i) \
        __builtin_amdgcn_global_load_lds((const unsigned*)((const char*)(gbase) + (voff)[_i]), (LAS unsigned*)(lds + (bufoff) + ldsw + _i * 8192), 16, 0, 0); } while (0)
#define PG8_LDA(dst, b, h) do { _Pragma("unroll") for (int m = 0; m < 4; ++m) _Pragma("unroll") for (int k = 0; k < 2; ++k) dst[m][k] = *(const LAS bf16x8*)(lds + PG8_SA(b, h) + aoff + m * 2048 + k * 1024); } while (0)
#define PG8_LDB(dst, b, h) do { _Pragma("unroll") for (int n = 0; n < 2; ++n) _Pragma("unroll") for (int k = 0; k < 2; ++k) dst[n][k] = *(const LAS bf16x8*)(lds + PG8_SB(b, h) + boff + n * 2048 + k * 1024); } while (0)
#define PG8_MMA(ai, bj, At, Bt) do { __builtin_amdgcn_s_setprio(1); _Pragma("unroll") for (int m = 0; m < 4; ++m) _Pragma("unroll") for (int n = 0; n < 2; ++n) _Pragma("unroll") for (int k = 0; k < 2; ++k) \
        acc[ai][bj][m][n] = __builtin_amdgcn_mfma_f32_16x16x32_bf16(Bt[n][k], At[m][k], acc[ai][bj][m][n], 0, 0, 0); __builtin_amdgcn_s_setprio(0); } while (0)
#define PG8_WAIT_V(n) asm volatile("s_waitcnt vmcnt(" #n ")" ::: "memory")
#define PG8_WAIT_L(n) asm volatile("s_waitcnt lgkmcnt(" #n ")" ::: "memory")
#define PG8_BAR __builtin_amdgcn_s_barrier()
#define PG8_SCHED __builtin_amdgcn_sched_barrier(0)
    Unit cur, nxt; int ui = 0;
    if (!S.next(0, cur)) return;
    f32x4 acc[2][2][4][2];
#pragma unroll
    for (int a = 0; a < 2; ++a)
#pragma unroll
        for (int b = 0; b < 2; ++b)
#pragma unroll
            for (int m = 0; m < 4; ++m)
#pragma unroll
                for (int n = 0; n < 2; ++n) acc[a][b][m][n] = (f32x4){0.f, 0.f, 0.f, 0.f};
    bf16x8 At[4][2], B0[2][2], B1[2][2];
    const char* cA = (const char*)g.A + (size_t)cur.pm * tstepA; const char* cB = (const char*)g.Bt + (size_t)cur.pn * tstepB;
    PG8_STAGE(PG8_SB(0, 0), cB, voffB); PG8_STAGE(PG8_SB(0, 1), cB + hstepB, voffB); PG8_STAGE(PG8_SA(0, 0), cA, voffA); PG8_STAGE(PG8_SA(0, 1), cA + hstepA, voffA);
    if (wr == 1) PG8_BAR;
    PG8_WAIT_V(2); PG8_BAR;
    PG8_STAGE(PG8_SB(1, 0), cB + kstep, voffB); PG8_STAGE(PG8_SA(1, 0), cA + kstep, voffA); PG8_STAGE(PG8_SB(1, 1), cB + hstepB + kstep, voffB);
    PG8_WAIT_V(6); PG8_BAR;
    for (;;) {
        const bool has_next = S.next(ui + 1, nxt);
        const char* nA = has_next ? (const char*)g.A + (size_t)nxt.pm * tstepA : cA; const char* nB = has_next ? (const char*)g.Bt + (size_t)nxt.pn * tstepB : cB;
        for (int t = 0; t < nt; t += 2) {
            const bool last = (t == nt - 2);
            const char* a1 = cA + (size_t)(t + 1) * kstep;
            const char* a2 = last ? nA : cA + (size_t)(t + 2) * kstep; const char* b2 = last ? nB : cB + (size_t)(t + 2) * kstep;
            const char* a3 = a2 + kstep; const char* b3 = b2 + kstep;
            PG8_LDB(B0, 0, 0); PG8_LDB(B1, 0, 1); PG8_SCHED; PG8_LDA(At, 0, 0); PG8_STAGE(PG8_SA(1, 1), a1 + hstepA, voffA);
            PG8_WAIT_V(8); PG8_WAIT_L(0); PG8_BAR; PG8_MMA(0, 0, At, B0); PG8_MMA(0, 1, At, B1); PG8_BAR; PG8_SCHED;
            PG8_LDA(At, 0, 1); PG8_STAGE(PG8_SB(0, 0), b2, voffB); PG8_STAGE(PG8_SB(0, 1), b2 + hstepB, voffB); PG8_STAGE(PG8_SA(0, 0), a2, voffA);
            PG8_WAIT_V(8); PG8_WAIT_L(0); PG8_BAR; PG8_MMA(1, 0, At, B0); PG8_MMA(1, 1, At, B1); PG8_BAR; PG8_SCHED;
            PG8_LDB(B0, 1, 0); PG8_LDB(B1, 1, 1); PG8_SCHED; PG8_LDA(At, 1, 0); PG8_STAGE(PG8_SA(0, 1), a2 + hstepA, voffA);
            PG8_WAIT_V(8); PG8_WAIT_L(0); PG8_BAR; PG8_MMA(0, 0, At, B0); PG8_MMA(0, 1, At, B1); PG8_BAR; PG8_SCHED;
            PG8_LDA(At, 1, 1); PG8_STAGE(PG8_SB(1, 0), b3, voffB); PG8_STAGE(PG8_SB(1, 1), b3 + hstepB, voffB); PG8_STAGE(PG8_SA(1, 0), a3, voffA);
            PG8_WAIT_V(8); PG8_WAIT_L(0); PG8_BAR; PG8_MMA(1, 0, At, B0); PG8_MMA(1, 1, At, B1); PG8_BAR; PG8_SCHED;
        }
        if (wr == 0) PG8_BAR;
        E(acc, cur, wr, wc, fr, fq);
        if (!has_next) break;
#pragma unroll
        for (int a = 0; a < 2; ++a)
#pragma unroll
            for (int b = 0; b < 2; ++b)
#pragma unroll
                for (int m = 0; m < 4; ++m)
#pragma unroll
                    for (int n = 0; n < 2; ++n) acc[a][b][m][n] = (f32x4){0.f, 0.f, 0.f, 0.f};
        cur = nxt; cA = nA; cB = nB; ++ui;
        if (wr == 1) PG8_BAR;
    }
    PG8_WAIT_V(0);
    PG8_BAR;
#undef PG8_SA
#undef PG8_SB
#undef PG8_STAGE
#undef PG8_LDA
#undef PG8_LDB
#undef PG8_MMA
#undef PG8_WAIT_V
#undef PG8_WAIT_L
#undef PG8_BAR
#undef PG8_SCHED
}

template <class F>
__device__ __forceinline__ void epi_foreach(const f32x4 (&acc)[2][2][4][2], const Unit& u, int wr_, int wc_, int fr_, int fq_, const F& f) {
    const int t_ = tid_(), wid_ = t_ >> 6, wr = wid_ >> 2, wc = wid_ & 3, fr = t_ & 15, fq = (t_ >> 4) & 3;
    const int row0 = u.pm * BM + wr * 64 + fr, col0 = u.pn * BM + wc * 32 + 8 * fq;
#pragma unroll
    for (int ai = 0; ai < 2; ++ai)
#pragma unroll
        for (int m = 0; m < 4; ++m) {
#pragma unroll
            for (int bj = 0; bj < 2; ++bj) f.op(row0 + ai * HALF + m * 16, col0 + bj * HALF, acc[ai][bj][m][0], acc[ai][bj][m][1]);
            asm volatile("" ::: "memory");
        }
}
struct EpiF32 {
    float* O; int ldc;
    __device__ __forceinline__ void op(int row, int col, f32x4 v0, f32x4 v1) const { float* p = O + (size_t)row * ldc + col; *(f32x4*)p = v0; *(f32x4*)(p + 4) = v1; }
    __device__ __forceinline__ void operator()(const f32x4 (&acc)[2][2][4][2], const Unit& u, int wr, int wc, int fr, int fq) const { epi_foreach(acc, u, wr, wc, fr, fq, *this); }
};
struct EpiBf16 {
    bf16_t* O; int ldc;
    __device__ __forceinline__ void op(int row, int col, f32x4 v0, f32x4 v1) const {
        u32x4 w; w.x = cvt_pk_bf16(v0[0], v0[1]); w.y = cvt_pk_bf16(v0[2], v0[3]); w.z = cvt_pk_bf16(v1[0], v1[1]); w.w = cvt_pk_bf16(v1[2], v1[3]);
        *(u32x4*)(O + (size_t)row * ldc + col) = w; }
    __device__ __forceinline__ void operator()(const f32x4 (&acc)[2][2][4][2], const Unit& u, int wr, int wc, int fr, int fq) const { epi_foreach(acc, u, wr, wc, fr, fq, *this); }
};
struct EpiSigT {
    float* T; const bf16_t* G; int goff;
    __device__ __forceinline__ void op(int row, int col, f32x4 v0, f32x4 v1) const {
        const u32x4 gw = *(const u32x4*)(G + (size_t)row * LD_G + goff + col); float gf[8]; unpack8(gw, gf);
        f32x4 o0, o1;
#pragma unroll
        for (int i = 0; i < 4; ++i) { o0[i] = sigmoidf_(gf[i]) * v0[i]; o1[i] = sigmoidf_(gf[4 + i]) * v1[i]; }
        float* p = T + (size_t)row * DM + col; *(f32x4*)p = o0; *(f32x4*)(p + 4) = o1; }
    __device__ __forceinline__ void operator()(const f32x4 (&acc)[2][2][4][2], const Unit& u, int wr, int wc, int fr, int fq) const { epi_foreach(acc, u, wr, wc, fr, fq, *this); }
};
struct EpiMix {
    bf16_t* O; const float* T; const bf16_t* G; int goff;
    __device__ __forceinline__ void op(int row, int col, f32x4 v0, f32x4 v1) const {
        const u32x4 gw = *(const u32x4*)(G + (size_t)row * LD_G + goff + col); float gf[8]; unpack8(gw, gf);
        const float* p = T + (size_t)row * DM + col; const f32x4 t0 = *(const f32x4*)p, t1 = *(const f32x4*)(p + 4);
        float o[8];
#pragma unroll
        for (int i = 0; i < 4; ++i) { o[i] = t0[i] + sigmoidf_(gf[i]) * v0[i]; o[4 + i] = t1[i] + sigmoidf_(gf[4 + i]) * v1[i]; }
        *(u32x4*)(O + (size_t)row * DM + col) = pack8(o); }
    __device__ __forceinline__ void operator()(const f32x4 (&acc)[2][2][4][2], const Unit& u, int wr, int wc, int fr, int fq) const { epi_foreach(acc, u, wr, wc, fr, fq, *this); }
};
struct EpiSigMulT {
    float* T;
    __device__ __forceinline__ void op(int row, int col, f32x4 v0, f32x4 v1) const {
        float* p = T + (size_t)row * DM + col; const f32x4 t0 = *(const f32x4*)p, t1 = *(const f32x4*)(p + 4); f32x4 o0, o1;
#pragma unroll
        for (int i = 0; i < 4; ++i) { o0[i] = sigmoidf_(v0[i]) * t0[i]; o1[i] = sigmoidf_(v1[i]) * t1[i]; }
        *(f32x4*)p = o0; *(f32x4*)(p + 4) = o1; }
    __device__ __forceinline__ void operator()(const f32x4 (&acc)[2][2][4][2], const Unit& u, int wr, int wc, int fr, int fq) const { epi_foreach(acc, u, wr, wc, fr, fq, *this); }
};
struct EpiProj {
    unsigned char* wsb; const float* rope; int grow0;
    __device__ __forceinline__ void operator()(const f32x4 (&acc)[2][2][4][2], const Unit& u, int wr_, int wc_, int fr_, int fq_) const {
        const int t_ = tid_(), wid_ = __builtin_amdgcn_readfirstlane(t_ >> 6), wr = wid_ >> 2, wc = wid_ & 3, fr = t_ & 15, fq = (t_ >> 4) & 3;
        const int row0 = u.pm * BM + wr * 64 + fr, col0 = u.pn * BM + wc * 32 + 8 * fq;
        const int pn = u.pn;
        size_t boff; int ld, cofs;
        if (pn < 9) { boff = OFF_QKV; ld = LD_QKV; cofs = 0; }
        else if (pn < 17) { boff = OFF_Z; ld = LD_Z; cofs = 2304; }
        else if (pn < 27) { boff = OFF_XBC; ld = LD_XBC; cofs = 4352; }
        else if (pn < 35) { boff = OFF_GATES; ld = LD_G; cofs = 6912; }
        else { boff = OFF_DT; ld = LD_DT; cofs = 8960; }
        bf16_t* base = (bf16_t*)(wsb + boff);
        const bool do_rope = (pn < 6) && ((wc & 1) == 0);
        const int paddr = (((fr + 16 * fq) ^ 16) << 2);
        const bool dt_skip = (pn >= 35) && (col0 - cofs >= LD_DT);
#pragma unroll
        for (int ai = 0; ai < 2; ++ai)
#pragma unroll
            for (int m = 0; m < 4; ++m) {
                const int row = row0 + ai * HALF + m * 16;
#pragma unroll
                for (int bj = 0; bj < 2; ++bj) {
                    const int c = col0 + bj * HALF - cofs;
                    float v[8];
#pragma unroll
                    for (int i = 0; i < 4; ++i) { v[i] = acc[ai][bj][m][0][i]; v[4 + i] = acc[ai][bj][m][1][i]; }
                    if (do_rope) {
                        float pr[8];
#pragma unroll
                        for (int i = 0; i < 8; ++i) pr[i] = __int_as_float(__builtin_amdgcn_ds_bpermute(paddr, __float_as_int(v[i])));
                        if (fq < 2) {
                            const int pos = seq_pos(grow0 + row);
                            const float* rt = rope + (size_t)pos * 16;
                            const f32x4 c0 = *(const f32x4*)rt, c1 = *(const f32x4*)(rt + 4), s0 = *(const f32x4*)(rt + 8), s1 = *(const f32x4*)(rt + 12);
                            const float sg = fq == 0 ? -1.f : 1.f;
#pragma unroll
                            for (int i = 0; i < 4; ++i) { v[i] = v[i] * c0[i] + sg * pr[i] * s0[i]; v[4 + i] = v[4 + i] * c1[i] + sg * pr[4 + i] * s1[i]; }
                        }
                    }
                    if (!(dt_skip || (pn >= 35 && bj == 1))) *(u32x4*)(base + (size_t)row * ld + c) = pack8(v);
                }
            }
    }
};
}

__device__ __forceinline__ void transpose_item(const float* W, int ldw, int K, int src_col0, bf16_t* WT, int dst_row0, const float* gain, LAS float* scr, int nblk, int item, int lane) {
    const int kb = item / nblk, nb = item % nblk, k0 = 64 * kb, n0 = 32 * nb;
#pragma unroll 8
    for (int i = 0; i < 32; ++i) { const int kk = 2 * i + (lane >> 5); const float gsc = gain ? gain[k0 + kk] : 1.f;
        scr[kk * 33 + (lane & 31)] = W[(size_t)(k0 + kk) * ldw + src_col0 + n0 + (lane & 31)] * gsc; }
    asm volatile("s_waitcnt lgkmcnt(0)" ::: "memory");
    const int c = lane & 7;
#pragma unroll
    for (int j = 0; j < 4; ++j) { const int n = (lane >> 3) + 8 * j; const LAS float* s = scr + (8 * c) * 33 + n;
        u32x4 o; o.x = cvt_pk_bf16(s[0 * 33], s[1 * 33]); o.y = cvt_pk_bf16(s[2 * 33], s[3 * 33]); o.z = cvt_pk_bf16(s[4 * 33], s[5 * 33]); o.w = cvt_pk_bf16(s[6 * 33], s[7 * 33]);
        *(u32x4*)(WT + (size_t)(dst_row0 + n0 + n) * K + k0 + 8 * c) = o; }
    asm volatile("s_waitcnt lgkmcnt(0)" ::: "memory");
}

__device__ __forceinline__ void prologue_phase(const Params& p, LAS unsigned char* lds) {
    const int tid = tid_(), lane = tid & 63, wave = tid >> 6;
    const int gw = blockIdx.x * NWAVE + wave, NGW = gridDim.x * NWAVE;
    LAS float* scr = (LAS float*)(lds + wave * 8704);
    unsigned char* ws = p.ws;
    int it0 = 0;
#define SEG(W_, ldw_, K_, src0_, ncols_, off_, drow0_, gain_) do { const int nblk = (ncols_) / 32, nitems = ((K_) / 64) * nblk; \
        const int first = (gw - (it0 % NGW) + NGW) % NGW; \
        for (int i = first; i < nitems; i += NGW) transpose_item((W_), (ldw_), (K_), (src0_), (bf16_t*)(ws + (off_)), (drow0_), (gain_), scr, nblk, i, lane); \
        it0 += nitems; } while (0)
    SEG(p.in[6], 9024, 1024, 0, 6912, OFF_W1, 0, p.in[4]);
    SEG(p.in[6], 9024, 1024, 6976, 2048, OFF_W1, 6912, p.in[4]);
    SEG(p.in[6], 9024, 1024, 6912, 64, OFF_W1, 8960, p.in[4]);
    SEG(p.in[13], 1024, 256, 0, 1024, OFF_WA, 0, (const float*)nullptr);
    SEG(p.in[14], 1024, 2048, 0, 1024, OFF_WM, 0, p.in[12]);
    SEG(p.in[15], 1024, 1024, 0, 1024, OFF_WO, 0, (const float*)nullptr);
    SEG(p.in[17], 4096, 1024, 0, 4096, OFF_WUP, 0, p.in[16]);
    SEG(p.in[20], 1024, 2048, 0, 1024, OFF_WDN, 0, (const float*)nullptr);
    SEG(p.in[22], 1024, 256, 0, 1024, OFF_WP, 0, (const float*)nullptr);
    SEG(p.in[23], 1024, 1024, 0, 1024, OFF_WG, 0, (const float*)nullptr);
#undef SEG
    { u32x4* z = (u32x4*)(ws + OFF_W1 + (size_t)9024 * 1024 * 2); const int n = 192 * 1024 * 2 / 16;
      for (int i = blockIdx.x * NTHR + tid; i < n; i += gridDim.x * NTHR) z[i] = (u32x4){0u, 0u, 0u, 0u}; }
    { float* rt = (float*)(ws + OFF_ROPE);
      for (int i = blockIdx.x * NTHR + tid; i < 4096 * 8; i += gridDim.x * NTHR) {
          const int pos = i >> 3, k = i & 7;
          double c;
          switch (k) { case 0: c = 0.15915494309189535; break; case 1: c = 0.030863763404701233; break; case 2: c = 0.005985185712713706; break; case 3: c = 0.001160663641240061; break;
                       case 4: c = 0.00022507907903927658; break; case 5: c = 4.364795279280288e-05; break; case 6: c = 8.464330808241401e-06; break; default: c = 1.641426262795035e-06; break; }
          double rev = (double)pos * c; rev -= (double)(long long)rev;
          const float fr = (float)rev;
          rt[pos * 16 + k] = __builtin_amdgcn_cosf(fr); rt[pos * 16 + 8 + k] = __builtin_amdgcn_sinf(fr);
      } }
}

__device__ __forceinline__ const float* x_row(const Params& p, int grow) { return grow < NPROMPT ? p.in[0] + (size_t)grow * DM : p.in[1] + (size_t)(grow - NPROMPT) * DM; }

__device__ __forceinline__ void prep_phase(const Params& p, int row0, int nrows) {
    const int tid__ = tid_(); const int lane = tid__ & 63, wave = tid__ >> 6;
    bf16_t* XS = (bf16_t*)(p.ws + OFF_XS);
    for (int r = blockIdx.x * NWAVE + wave; r < nrows; r += gridDim.x * NWAVE) {
        const f32x4* xr = (const f32x4*)x_row(p, row0 + r) + lane;
        f32x4 v[4]; float s = 0.f;
#pragma unroll
        for (int j = 0; j < 4; ++j) { v[j] = xr[64 * j]; s += (v[j].x * v[j].x + v[j].y * v[j].y) + (v[j].z * v[j].z + v[j].w * v[j].w); }
        const float rs = rsqrtf(wave_sum(s) * (1.f / DM) + EPS);
        u32x2* o = (u32x2*)(XS + (size_t)r * DM) + lane;
#pragma unroll
        for (int j = 0; j < 4; ++j) { u32x2 w; w.x = cvt_pk_bf16(v[j].x * rs, v[j].y * rs); w.y = cvt_pk_bf16(v[j].z * rs, v[j].w * rs); o[64 * j] = w; }
    }
}
__device__ __forceinline__ void post_mix_phase(const Params& p, int row0, int nrows) {
    const int tid__ = tid_(); const int lane = tid__ & 63, wave = tid__ >> 6;
    bf16_t* XS = (bf16_t*)(p.ws + OFF_XS); const float* MIX = (const float*)(p.ws + OFF_QKV);
    const f32x4* gp = (const f32x4*)p.in[5] + lane;
    for (int r = blockIdx.x * NWAVE + wave; r < nrows; r += gridDim.x * NWAVE) {
        const f32x4* mr = (const f32x4*)(MIX + (size_t)r * DM) + lane; const f32x4* xr = (const f32x4*)x_row(p, row0 + r) + lane;
        f32x4 v[4]; float s = 0.f;
#pragma unroll
        for (int j = 0; j < 4; ++j) { v[j] = mr[64 * j]; s += (v[j].x * v[j].x + v[j].y * v[j].y) + (v[j].z * v[j].z + v[j].w * v[j].w); }
        const float rs = rsqrtf(wave_sum(s) * (1.f / DM) + EPS);
        float s2 = 0.f;
        f32x4* orow = (f32x4*)(p.out + (size_t)(row0 + r) * DM) + lane;
#pragma unroll
        for (int j = 0; j < 4; ++j) { v[j] = xr[64 * j] + v[j] * rs * gp[64 * j]; orow[64 * j] = v[j]; s2 += (v[j].x * v[j].x + v[j].y * v[j].y) + (v[j].z * v[j].z + v[j].w * v[j].w); }
        const float rs2 = rsqrtf(wave_sum(s2) * (1.f / DM) + EPS);
        u32x2* o = (u32x2*)(XS + (size_t)r * DM) + lane;
#pragma unroll
        for (int j = 0; j < 4; ++j) { u32x2 w; w.x = cvt_pk_bf16(v[j].x * rs2, v[j].y * rs2); w.y = cvt_pk_bf16(v[j].z * rs2, v[j].w * rs2); o[64 * j] = w; }
    }
}
__device__ __forceinline__ void post_ffn_phase(const Params& p, int row0, int nrows) {
    const int tid__ = tid_(); const int lane = tid__ & 63, wave = tid__ >> 6;
    bf16_t* XS = (bf16_t*)(p.ws + OFF_XS); const float* F = (const float*)(p.ws + OFF_QKV); bf16_t* PB = (bf16_t*)(p.ws + OFF_ATT);
    const f32x4* gp = (const f32x4*)p.in[21] + lane;
    for (int r = blockIdx.x * NWAVE + wave; r < nrows; r += gridDim.x * NWAVE) {
        const f32x4* fr_ = (const f32x4*)(F + (size_t)r * DM) + lane;
        f32x4* orow = (f32x4*)(p.out + (size_t)(row0 + r) * DM) + lane;
        f32x4 v[4]; float s = 0.f;
#pragma unroll
        for (int j = 0; j < 4; ++j) { v[j] = fr_[64 * j]; s += (v[j].x * v[j].x + v[j].y * v[j].y) + (v[j].z * v[j].z + v[j].w * v[j].w); }
        const float rs = rsqrtf(wave_sum(s) * (1.f / DM) + EPS);
        u32x2* o = (u32x2*)(XS + (size_t)r * DM) + lane;
#pragma unroll
        for (int j = 0; j < 4; ++j) { v[j] = orow[64 * j] + v[j] * rs * gp[64 * j]; orow[64 * j] = v[j];
            u32x2 w; w.x = cvt_pk_bf16(v[j].x, v[j].y); w.y = cvt_pk_bf16(v[j].z, v[j].w); o[64 * j] = w; }
        const int grow = row0 + r;
        const float* pr = grow < NPROMPT ? p.in[2] + (size_t)grow * 256 : p.in[3] + (size_t)(grow - NPROMPT) * 256;
        const f32x4 pv = ((const f32x4*)pr)[lane];
        u32x2 w; w.x = cvt_pk_bf16(pv.x, pv.y); w.y = cvt_pk_bf16(pv.z, pv.w); ((u32x2*)(PB + (size_t)r * 256))[lane] = w;
    }
}
__device__ __forceinline__ void post_ple_phase(const Params& p, int row0, int nrows) {
    const int tid__ = tid_(); const int lane = tid__ & 63, wave = tid__ >> 6;
    const float* PE = (const float*)(p.ws + OFF_Z);
    const f32x4* gp = (const f32x4*)p.in[24] + lane;
    for (int r = blockIdx.x * NWAVE + wave; r < nrows; r += gridDim.x * NWAVE) {
        const f32x4* er = (const f32x4*)(PE + (size_t)r * DM) + lane;
        f32x4* orow = (f32x4*)(p.out + (size_t)(row0 + r) * DM) + lane;
        f32x4 v[4]; float s = 0.f;
#pragma unroll
        for (int j = 0; j < 4; ++j) { v[j] = er[64 * j]; s += (v[j].x * v[j].x + v[j].y * v[j].y) + (v[j].z * v[j].z + v[j].w * v[j].w); }
        const float rs = rsqrtf(wave_sum(s) * (1.f / DM) + EPS);
#pragma unroll
        for (int j = 0; j < 4; ++j) orow[64 * j] = orow[64 * j] + v[j] * rs * gp[64 * j];
    }
}

__device__ __forceinline__ float gelu_tanh(float x) {
    const float u = 0.7978845608028654f * (x + 0.044715f * x * x * x);
    const float t = 1.f - 2.f / (__expf(2.f * u) + 1.f);
    return 0.5f * x * (1.f + t);
}
template <int MODE>
__device__ __forceinline__ void conv_phase(const Params& p, int row0, int nrows) {
    constexpr int LDI = MODE == 0 ? LD_XBC : 4096, NCG = MODE == 0 ? 320 : 256, LDO = MODE == 0 ? LD_XBC : 2048, NCH = MODE == 0 ? 2560 : 4096;
    const bf16_t* src = (const bf16_t*)(p.ws + (MODE == 0 ? OFF_XBC : OFF_Z));
    bf16_t* dst = (bf16_t*)(p.ws + (MODE == 0 ? OFF_XBCC : OFF_GATES));
    const float* cw = MODE == 0 ? p.in[7] : p.in[18]; const float* cb = MODE == 0 ? p.in[8] : p.in[19];
    const int ntask = (nrows / 16) * NCG;
    const int tid__ = tid_();
    for (int task = blockIdx.x * NTHR + tid__; task < ntask; task += gridDim.x * NTHR) {
        const int cg_ = task % NCG, tb = task / NCG, c = cg_ * 8, t0 = tb * 16;
        const int pos0 = seq_pos(row0 + t0), S = seq_len(row0 + t0);
        float w0[8], w1[8], w2[8], bb[8];
#pragma unroll
        for (int i = 0; i < 8; ++i) { w0[i] = cw[c + i]; w1[i] = cw[NCH + c + i]; w2[i] = cw[2 * NCH + c + i]; bb[i] = cb[c + i]; }
        float v0[8], v1[8], v2[8], bv[8];
        if (MODE == 1) {
#pragma unroll
            for (int i = 0; i < 8; ++i) { v0[i] = cw[2048 + c + i]; v1[i] = cw[NCH + 2048 + c + i]; v2[i] = cw[2 * NCH + 2048 + c + i]; bv[i] = cb[2048 + c + i]; }
        }
        const u32x4 zero4 = (u32x4){0u, 0u, 0u, 0u};
        const bf16_t* sp = src + (size_t)t0 * LDI + c;
        u32x4 pg = pos0 > 0 ? *(const u32x4*)(sp - LDI) : zero4, cgv = *(const u32x4*)sp, pv = zero4, cv = zero4;
        if (MODE == 1) { pv = pos0 > 0 ? *(const u32x4*)(sp - LDI + 2048) : zero4; cv = *(const u32x4*)(sp + 2048); }
        const bool has_next = (pos0 + 16) < S;
#pragma unroll 1
        for (int i = 0; i < 16; ++i) {
            const bool ld = (i < 15) || has_next;
            const u32x4 ng = ld ? *(const u32x4*)(sp + (size_t)(i + 1) * LDI) : zero4;
            u32x4 nv = zero4; if (MODE == 1) nv = ld ? *(const u32x4*)(sp + (size_t)(i + 1) * LDI + 2048) : zero4;
            float a[8], b[8], d[8], o[8]; unpack8(pg, a); unpack8(cgv, b); unpack8(ng, d);
#pragma unroll
            for (int k = 0; k < 8; ++k) o[k] = w0[k] * a[k] + w1[k] * b[k] + w2[k] * d[k] + bb[k];
            if (MODE == 0) {
#pragma unroll
                for (int k = 0; k < 8; ++k) o[k] = o[k] * sigmoidf_(o[k]);
            } else {
                float a2[8], b2[8], d2[8]; unpack8(pv, a2); unpack8(cv, b2); unpack8(nv, d2);
#pragma unroll
                for (int k = 0; k < 8; ++k) o[k] = gelu_tanh(o[k]) * (v0[k] * a2[k] + v1[k] * b2[k] + v2[k] * d2[k] + bv[k]);
            }
            *(u32x4*)(dst + (size_t)(t0 + i) * LDO + c) = pack8(o);
            pg = cgv; cgv = ng; if (MODE == 1) { pv = cv; cv = nv; }
        }
    }
    if (MODE == 0) {
        const bf16_t* DT = (const bf16_t*)(p.ws + OFF_DT); float* DTF = (float*)(p.ws + OFF_DTF);
        for (int i = blockIdx.x * NTHR + tid__; i < nrows * 64; i += gridDim.x * NTHR) {
            const float x = __uint_as_float((unsigned)DT[i] << 16) + p.in[10][i & 63];
            const float u = __expf(x); DTF[i] = x > 20.f ? x : (u < 0.03f ? u * (1.f - u * (0.5f - u * (1.f / 3.f))) : __logf(1.f + u));
        }
    }
}

constexpr int VT_LD = 196;
__device__ __forceinline__ void attn_phase(const Params& p, int row0, int nrows, LAS unsigned char* lds) {
    const int tid = tid_(), lane = tid & 63, wave = tid >> 6, l16 = lane & 15, quad = lane >> 4;
    const int head = wave >> 1, half = wave & 1;
    bf16_t* QKV = (bf16_t*)(p.ws + OFF_QKV); float* LSE = (float*)(p.ws + OFF_LSE);
    LAS bf16_t* Vt = (LAS bf16_t*)lds;
    const int NB = nrows / 64, nitems = NB * 3;
#pragma unroll 1
    for (int it = blockIdx.x; it < nitems; it += gridDim.x) {
        const int g = it / NB, blk = it % NB;
        const int dsh = 2 * g, dil = 1 << dsh;
        const int grow = row0 + blk * 64, S = seq_len(grow);
        const int sstart = (grow < NPROMPT ? (grow & ~2047) : (grow & ~4095)) - row0;
        const int idx = (grow - row0 - sstart) >> 6, nq = S >> (6 + dsh), r = idx / nq, qb = idx % nq, L = S >> dsh;
        __syncthreads();
#pragma unroll 1
        for (int i = 0; i < 12; ++i) {
            const int id = tid + NTHR * i, c = id & 7, kk = (id >> 3) % 192, hh = id / 1536;
            int l = qb * 64 - 64 + kk; l = l < 0 ? 0 : (l >= L ? L - 1 : l);
            const u32x4 w = *(const u32x4*)(QKV + (size_t)(sstart + l * dil + r) * LD_QKV + 1536 + (g * 4 + hh) * 64 + 8 * c);
            LAS bf16_t* d = Vt + (hh * 64 + 8 * c) * VT_LD + kk;
            d[0 * VT_LD] = (bf16_t)(w.x & 0xffffu); d[1 * VT_LD] = (bf16_t)(w.x >> 16); d[2 * VT_LD] = (bf16_t)(w.y & 0xffffu); d[3 * VT_LD] = (bf16_t)(w.y >> 16);
            d[4 * VT_LD] = (bf16_t)(w.z & 0xffffu); d[5 * VT_LD] = (bf16_t)(w.z >> 16); d[6 * VT_LD] = (bf16_t)(w.w & 0xffffu); d[7 * VT_LD] = (bf16_t)(w.w >> 16);
        }
        const int q0 = qb * 64 + 32 * half;
        bf16x8 Qf[2][2];
#pragma unroll
        for (int qt = 0; qt < 2; ++qt)
#pragma unroll
            for (int ks = 0; ks < 2; ++ks)
                Qf[qt][ks] = *(const bf16x8*)(QKV + (size_t)(sstart + (q0 + 16 * qt + l16) * dil + r) * LD_QKV + (g * 4 + head) * 64 + 32 * ks + 8 * quad);
        f32x4 sc[10][2];
#pragma unroll
        for (int kt = 0; kt < 10; ++kt) {
            int l = q0 - 64 + 16 * kt + l16; l = l < 0 ? 0 : (l >= L ? L - 1 : l);
            const bf16_t* kp = QKV + (size_t)(sstart + l * dil + r) * LD_QKV + 768 + (g * 4 + head) * 64 + 8 * quad;
            const bf16x8 k0 = *(const bf16x8*)kp, k1 = *(const bf16x8*)(kp + 32);
#pragma unroll
            for (int qt = 0; qt < 2; ++qt) {
                f32x4 a = (f32x4){0.f, 0.f, 0.f, 0.f};
                a = __builtin_amdgcn_mfma_f32_16x16x32_bf16(k0, Qf[qt][0], a, 0, 0, 0);
                a = __builtin_amdgcn_mfma_f32_16x16x32_bf16(k1, Qf[qt][1], a, 0, 0, 0);
                sc[kt][qt] = a;
            }
        }
        float mx[2], sm[2];
#pragma unroll
        for (int qt = 0; qt < 2; ++qt) {
            const int qq = q0 + 16 * qt + l16;
            float m = -3.0e38f;
#pragma unroll
            for (int kt = 0; kt < 10; ++kt)
#pragma unroll
                for (int j = 0; j < 4; ++j) {
                    const int l = q0 - 64 + 16 * kt + 4 * quad + j, dd = qq - l;
                    const bool ok = (l >= 0) && (l < L) && (dd <= 64) && (dd >= -64);
                    const float s = ok ? sc[kt][qt][j] * 0.125f : -1.0e30f;
                    sc[kt][qt][j] = s; m = fmaxf(m, s);
                }
            m = fmaxf(m, __shfl_xor(m, 16)); m = fmaxf(m, __shfl_xor(m, 32));
            float su = 0.f;
#pragma unroll
            for (int kt = 0; kt < 10; ++kt)
#pragma unroll
                for (int j = 0; j < 4; ++j) { const float e = __expf(sc[kt][qt][j] - m); sc[kt][qt][j] = e; su += e; }
            su += __shfl_xor(su, 16); su += __shfl_xor(su, 32);
            mx[qt] = m; sm[qt] = su;
        }
        __syncthreads();
        f32x4 oc[4][2];
#pragma unroll
        for (int dt = 0; dt < 4; ++dt) { oc[dt][0] = (f32x4){0.f, 0.f, 0.f, 0.f}; oc[dt][1] = (f32x4){0.f, 0.f, 0.f, 0.f}; }
#pragma unroll
        for (int ks = 0; ks < 5; ++ks) {
            bf16x8 pb[2];
#pragma unroll
            for (int qt = 0; qt < 2; ++qt) {
                u32x4 w; w.x = cvt_pk_bf16(sc[2 * ks][qt][0], sc[2 * ks][qt][1]); w.y = cvt_pk_bf16(sc[2 * ks][qt][2], sc[2 * ks][qt][3]);
                w.z = cvt_pk_bf16(sc[2 * ks + 1][qt][0], sc[2 * ks + 1][qt][1]); w.w = cvt_pk_bf16(sc[2 * ks + 1][qt][2], sc[2 * ks + 1][qt][3]);
                pb[qt] = __builtin_bit_cast(bf16x8, w);
            }
#pragma unroll
            for (int dt = 0; dt < 4; ++dt) {
                const LAS bf16_t* vp = Vt + (head * 64 + 16 * dt + l16) * VT_LD + 32 * half + 32 * ks + 4 * quad;
                const u32x2 a0 = *(const LAS u32x2*)vp, a1 = *(const LAS u32x2*)(vp + 16);
                u32x4 aw; aw.x = a0.x; aw.y = a0.y; aw.z = a1.x; aw.w = a1.y;
                const bf16x8 af = __builtin_bit_cast(bf16x8, aw);
                oc[dt][0] = __builtin_amdgcn_mfma_f32_16x16x32_bf16(af, pb[0], oc[dt][0], 0, 0, 0);
                oc[dt][1] = __builtin_amdgcn_mfma_f32_16x16x32_bf16(af, pb[1], oc[dt][1], 0, 0, 0);
            }
        }
#pragma unroll
        for (int qt = 0; qt < 2; ++qt) {
            const int qrow = sstart + (q0 + 16 * qt + l16) * dil + r;
            const float inv = 1.f / sm[qt];
#pragma unroll
            for (int dt = 0; dt < 4; ++dt) {
                u32x2 w; w.x = cvt_pk_bf16(oc[dt][qt][0] * inv, oc[dt][qt][1] * inv); w.y = cvt_pk_bf16(oc[dt][qt][2] * inv, oc[dt][qt][3] * inv);
                *(u32x2*)(QKV + (size_t)qrow * LD_QKV + (g * 4 + head) * 64 + 16 * dt + 4 * quad) = w;
            }
            if (quad == 0) LSE[(size_t)qrow * 16 + g * 4 + head] = mx[qt] + __logf(sm[qt]);
        }
    }
}

constexpr int SLD = 72;
constexpr int SSD_SET = 3 * 64 * SLD * 2;
template <int DIR>
__device__ __forceinline__ void ssd_dir(const Params& p, LAS unsigned char* lds, int sstart, int S, int h) {
    const int tid = tid_(), lane = tid & 63, wave = tid >> 6, l16 = lane & 15, quad = lane >> 4;
    const int tt = wave >> 1, ph = wave & 1;
    const int spt = wave >> 1, snh = wave & 1;
    const int gI = h >> 3;
    bf16_t* XBCC = (bf16_t*)(p.ws + OFF_XBCC); const float* DTF = (const float*)(p.ws + OFF_DTF);
    bf16_t* YOB = (bf16_t*)(p.ws + OFF_XBC); const bf16_t* Z = (const bf16_t*)(p.ws + OFF_Z); float* SSQ = (float*)(p.ws + OFF_SSQ);
    const float aF = -__expf(p.in[9][h]), aB = -__expf(p.in[9][32 + h]);
    const float dsk = p.in[11][h];
    f32x4 Hst[2]; Hst[0] = (f32x4){0.f, 0.f, 0.f, 0.f}; Hst[1] = (f32x4){0.f, 0.f, 0.f, 0.f};
    const int nch = S >> 6;
    const int srow = tid >> 3, ch8 = tid & 7;
#pragma unroll 1
    for (int step = 0; step < nch; ++step) {
        const int c = DIR == 0 ? step : nch - 1 - step;
        const int rb = sstart + c * 64;
        LAS bf16_t* Xt = (LAS bf16_t*)(lds + (step & 1) * SSD_SET);
        LAS bf16_t* Bwt = Xt + 64 * SLD;
        LAS bf16_t* Hs = Bwt + 64 * SLD;
        const float dtf = DTF[(size_t)(rb + lane) * 64 + h], dtb = DTF[(size_t)(rb + lane) * 64 + 32 + h];
        float acsf = dtf * aF, acsb = dtb * aB;
        if (DIR == 0) {
#pragma unroll
            for (int o = 1; o < 64; o <<= 1) { const float u = __shfl_up(acsf, o); if (lane >= o) acsf += u; }
        }
#pragma unroll
        for (int o = 1; o < 64; o <<= 1) { const float u = __shfl_down(acsb, o); if (lane + o < 64) acsb += u; }
        const float aend = DIR == 0 ? __shfl(acsf, 63) : __shfl(acsb, 0);
        const float wv = DIR == 0 ? __expf(aend - acsf) * dtf : __expf(aend - acsb) * dtb;
        const float cdec = __expf(aend);
        {
            const u32x4 xw = *(const u32x4*)(XBCC + (size_t)(rb + srow) * LD_XBC + h * 64 + 8 * ch8);
            const u32x4 bw = *(const u32x4*)(XBCC + (size_t)(rb + srow) * LD_XBC + 2048 + gI * 64 + 8 * ch8);
            const float ws_ = __shfl(wv, srow);
            float bfv[8]; unpack8(bw, bfv);
#pragma unroll
            for (int i = 0; i < 8; ++i) bfv[i] *= ws_;
            const u32x4 bs = pack8(bfv);
            LAS bf16_t* dx = Xt + (8 * ch8) * SLD + srow; LAS bf16_t* db = Bwt + (8 * ch8) * SLD + srow;
            dx[0 * SLD] = (bf16_t)(xw.x & 0xffffu); dx[1 * SLD] = (bf16_t)(xw.x >> 16); dx[2 * SLD] = (bf16_t)(xw.y & 0xffffu); dx[3 * SLD] = (bf16_t)(xw.y >> 16);
            dx[4 * SLD] = (bf16_t)(xw.z & 0xffffu); dx[5 * SLD] = (bf16_t)(xw.z >> 16); dx[6 * SLD] = (bf16_t)(xw.w & 0xffffu); dx[7 * SLD] = (bf16_t)(xw.w >> 16);
            db[0 * SLD] = (bf16_t)(bs.x & 0xffffu); db[1 * SLD] = (bf16_t)(bs.x >> 16); db[2 * SLD] = (bf16_t)(bs.y & 0xffffu); db[3 * SLD] = (bf16_t)(bs.y >> 16);
            db[4 * SLD] = (bf16_t)(bs.z & 0xffffu); db[5 * SLD] = (bf16_t)(bs.z >> 16); db[6 * SLD] = (bf16_t)(bs.w & 0xffffu); db[7 * SLD] = (bf16_t)(bs.w >> 16);
#pragma unroll
            for (int i = 0; i < 2; ++i) {
                u32x2 w; w.x = cvt_pk_bf16(Hst[i][0], Hst[i][1]); w.y = cvt_pk_bf16(Hst[i][2], Hst[i][3]);
                *(LAS u32x2*)(Hs + (16 * spt + l16) * SLD + 16 * (2 * snh + i) + 4 * quad) = w;
            }
        }
        __syncthreads();
        bf16x8 Cf[2];
        { const bf16_t* cp = XBCC + (size_t)(rb + 16 * tt + l16) * LD_XBC + 2304 + gI * 64 + 8 * quad; Cf[0] = *(const bf16x8*)cp; Cf[1] = *(const bf16x8*)(cp + 32); }
        f32x4 yo[2];
#pragma unroll
        for (int i = 0; i < 2; ++i) {
            const LAS bf16_t* hp = Hs + (16 * (2 * ph + i) + l16) * SLD + 8 * quad;
            f32x4 a = (f32x4){0.f, 0.f, 0.f, 0.f};
            a = __builtin_amdgcn_mfma_f32_16x16x32_bf16(*(const LAS bf16x8*)hp, Cf[0], a, 0, 0, 0);
            a = __builtin_amdgcn_mfma_f32_16x16x32_bf16(*(const LAS bf16x8*)(hp + 32), Cf[1], a, 0, 0, 0);
            yo[i] = a;
        }
        const int tl = 16 * tt + l16;
        const float et = __expf(DIR == 0 ? __shfl(acsf, tl) : __shfl(acsb, tl));
        yo[0] = yo[0] * et; yo[1] = yo[1] * et;
        if (DIR == 1) {
#pragma unroll
            for (int i = 0; i < 2; ++i) {
                u32x2 w; w.x = cvt_pk_bf16(yo[i][0], yo[i][1]); w.y = cvt_pk_bf16(yo[i][2], yo[i][3]);
                *(u32x2*)(YOB + (size_t)(rb + tl) * 2048 + h * 64 + 16 * (2 * ph + i) + 4 * quad) = w;
            }
        } else {
            f32x4 cb[4];
#pragma unroll
            for (int st = 0; st < 4; ++st) {
                const bf16_t* bp = XBCC + (size_t)(rb + 16 * st + l16) * LD_XBC + 2048 + gI * 64 + 8 * quad;
                f32x4 a = (f32x4){0.f, 0.f, 0.f, 0.f};
                a = __builtin_amdgcn_mfma_f32_16x16x32_bf16(*(const bf16x8*)bp, Cf[0], a, 0, 0, 0);
                a = __builtin_amdgcn_mfma_f32_16x16x32_bf16(*(const bf16x8*)(bp + 32), Cf[1], a, 0, 0, 0);
                cb[st] = a;
            }
            const float acsf_t = __shfl(acsf, tl), acsb_t = __shfl(acsb, tl);
#pragma unroll
            for (int st = 0; st < 4; ++st)
#pragma unroll
                for (int j = 0; j < 4; ++j) {
                    const int s = 16 * st + 4 * quad + j;
                    const float af_s = __shfl(acsf, s), ab_s = __shfl(acsb, s), df_s = __shfl(dtf, s), db_s = __shfl(dtb, s);
                    const float ef = __expf(fminf(acsf_t - af_s, 0.f)) * df_s, eb = __expf(fminf(acsb_t - ab_s, 0.f)) * db_s;
                    const float mm = (s <= tl ? ef : 0.f) + (s >= tl ? eb : 0.f);
                    cb[st][j] *= mm;
                }
            f32x4 yd[2]; yd[0] = (f32x4){0.f, 0.f, 0.f, 0.f}; yd[1] = (f32x4){0.f, 0.f, 0.f, 0.f};
#pragma unroll
            for (int ks = 0; ks < 2; ++ks) {
                u32x4 w; w.x = cvt_pk_bf16(cb[2 * ks][0], cb[2 * ks][1]); w.y = cvt_pk_bf16(cb[2 * ks][2], cb[2 * ks][3]);
                w.z = cvt_pk_bf16(cb[2 * ks + 1][0], cb[2 * ks + 1][1]); w.w = cvt_pk_bf16(cb[2 * ks + 1][2], cb[2 * ks + 1][3]);
                const bf16x8 gb = __builtin_bit_cast(bf16x8, w);
#pragma unroll
                for (int i = 0; i < 2; ++i) {
                    const LAS bf16_t* xp = Xt + (16 * (2 * ph + i) + l16) * SLD + 32 * ks + 4 * quad;
                    const u32x2 a0 = *(const LAS u32x2*)xp, a1 = *(const LAS u32x2*)(xp + 16);
                    u32x4 aw; aw.x = a0.x; aw.y = a0.y; aw.z = a1.x; aw.w = a1.y;
                    yd[i] = __builtin_amdgcn_mfma_f32_16x16x32_bf16(__builtin_bit_cast(bf16x8, aw), gb, yd[i], 0, 0, 0);
                }
            }
            float ss = 0.f;
            const size_t trow = (size_t)(rb + tl);
#pragma unroll
            for (int i = 0; i < 2; ++i) {
                const int pc = h * 64 + 16 * (2 * ph + i) + 4 * quad;
                const u32x2 xw = *(const u32x2*)(XBCC + trow * LD_XBC + pc), zw = *(const u32x2*)(Z + trow * LD_Z + pc), ow = *(const u32x2*)(YOB + trow * 2048 + pc);
                const float xv[4] = {bf_lo(xw.x), bf_hi(xw.x), bf_lo(xw.y), bf_hi(xw.y)};
                const float zv[4] = {bf_lo(zw.x), bf_hi(zw.x), bf_lo(zw.y), bf_hi(zw.y)};
                const float ov[4] = {bf_lo(ow.x), bf_hi(ow.x), bf_lo(ow.y), bf_hi(ow.y)};
                float r4[4];
#pragma unroll
                for (int j = 0; j < 4; ++j) { const float y = yd[i][j] + yo[i][j] + ov[j] + dsk * xv[j]; const float v = y * zv[j] * sigmoidf_(zv[j]); r4[j] = v; ss += v * v; }
                u32x2 w; w.x = cvt_pk_bf16(r4[0], r4[1]); w.y = cvt_pk_bf16(r4[2], r4[3]);
                *(u32x2*)(XBCC + trow * LD_XBC + pc) = w;
            }
            ss += __shfl_xor(ss, 16); ss += __shfl_xor(ss, 32);
            if (quad == 0) SSQ[trow * 64 + h * 2 + ph] = ss;
        }
#pragma unroll
        for (int i = 0; i < 2; ++i) {
            const LAS bf16_t* ap = Bwt + (16 * (2 * snh + i) + l16) * SLD + 8 * quad;
            const LAS bf16_t* bp = Xt + (16 * spt + l16) * SLD + 8 * quad;
            f32x4 a = Hst[i] * cdec;
            a = __builtin_amdgcn_mfma_f32_16x16x32_bf16(*(const LAS bf16x8*)ap, *(const LAS bf16x8*)bp, a, 0, 0, 0);
            a = __builtin_amdgcn_mfma_f32_16x16x32_bf16(*(const LAS bf16x8*)(ap + 32), *(const LAS bf16x8*)(bp + 32), a, 0, 0, 0);
            Hst[i] = a;
        }
    }
}
__device__ __forceinline__ void ssd_phase(const Params& p, int row0, int nrows, LAS unsigned char* lds) {
    const int np_rows = row0 < NPROMPT ? (NPROMPT - row0 < nrows ? NPROMPT - row0 : nrows) : 0;
    const int np_ = np_rows / 2048, ns = (nrows - np_rows) / 4096;
    const int nitems = (np_ + ns) * 32;
#pragma unroll 1
    for (int it = blockIdx.x; it < nitems; it += gridDim.x) {
        int sstart, S, h;
        if (it < ns * 32) { sstart = np_rows + (it >> 5) * 4096; S = 4096; h = it & 31; }
        else { const int j = it - ns * 32; sstart = (j >> 5) * 2048; S = 2048; h = j & 31; }
        __syncthreads();
        ssd_dir<1>(p, lds, sstart, S, h);
        __syncthreads();
        ssd_dir<0>(p, lds, sstart, S, h);
    }
}

__device__ __forceinline__ void combine_phase(const Params& p, int nrows) {
    const int tid__ = tid_(); const int lane = tid__ & 63, wave = tid__ >> 6;
    bf16_t* XBCC = (bf16_t*)(p.ws + OFF_XBCC); const float* SSQ = (const float*)(p.ws + OFF_SSQ);
    const bf16_t* O = (const bf16_t*)(p.ws + OFF_QKV); const float* LSE = (const float*)(p.ws + OFF_LSE); bf16_t* ATT = (bf16_t*)(p.ws + OFF_ATT);
    for (int r = blockIdx.x * NWAVE + wave; r < nrows; r += gridDim.x * NWAVE) {
        float s = SSQ[(size_t)r * 64 + lane];
        s += __shfl_xor(s, 1); s += __shfl_xor(s, 2); s += __shfl_xor(s, 4); s += __shfl_xor(s, 8);
        const float rs = rsqrtf(s * (1.f / 512.f) + EPS);
        u32x4* yp = (u32x4*)(XBCC + (size_t)r * LD_XBC + 32 * lane);
#pragma unroll
        for (int j = 0; j < 4; ++j) { float f[8]; unpack8(yp[j], f);
#pragma unroll
            for (int i = 0; i < 8; ++i) f[i] *= rs;
            yp[j] = pack8(f); }
        const int hh = lane >> 4, d = 4 * (lane & 15);
        const float l0 = LSE[(size_t)r * 16 + hh], l1 = LSE[(size_t)r * 16 + 4 + hh], l2 = LSE[(size_t)r * 16 + 8 + hh];
        const float m = fmaxf(l0, fmaxf(l1, l2));
        float w0 = __expf(l0 - m), w1 = __expf(l1 - m), w2 = __expf(l2 - m); const float inv = 1.f / (w0 + w1 + w2); w0 *= inv; w1 *= inv; w2 *= inv;
        const bf16_t* op = O + (size_t)r * LD_QKV + hh * 64 + d;
        const u32x2 a = *(const u32x2*)op, b = *(const u32x2*)(op + 256), c = *(const u32x2*)(op + 512);
        u32x2 w;
        w.x = cvt_pk_bf16(w0 * bf_lo(a.x) + w1 * bf_lo(b.x) + w2 * bf_lo(c.x), w0 * bf_hi(a.x) + w1 * bf_hi(b.x) + w2 * bf_hi(c.x));
        w.y = cvt_pk_bf16(w0 * bf_lo(a.y) + w1 * bf_lo(b.y) + w2 * bf_lo(c.y), w0 * bf_hi(a.y) + w1 * bf_hi(b.y) + w2 * bf_hi(c.y));
        *(u32x2*)(ATT + (size_t)r * 256 + hh * 64 + d) = w;
    }
}

__device__ __forceinline__ const Params& kparams() {
    typedef const __attribute__((address_space(4))) Params* KP;
    KP kp = (KP)__builtin_amdgcn_kernarg_segment_ptr();
    asm volatile("" : "+s"(kp));
    return *(const Params*)kp;
}
#define p kparams()
#define ws (kparams().ws)
__global__ void __launch_bounds__(NTHR, 2) mega_fwd(Params p_unused) {
    extern __shared__ __attribute__((aligned(16))) unsigned char smem[];
    LAS unsigned char* lds = (LAS unsigned char*)smem;
    const int G = gridDim.x, bid = blockIdx.x;

    prologue_phase(p, lds);
    prep_phase(p, p.prow0[0], p.pnrows[0]);
    cg::this_grid().sync();

#pragma unroll 1
    for (int ps = 0; ps < p.npass; ++ps) {
        const int row0 = p.prow0[ps], nrows = p.pnrows[ps];
        if (ps > 0) { prep_phase(p, row0, nrows); cg::this_grid().sync(); }
        {
            pg8::Gemm g{(const bf16_t*)(ws + OFF_XS), (const bf16_t*)(ws + OFF_W1), nrows, N1, 1024, 1024, 1024};
            pg8::StaticOrder S; S.init(nrows, N1, G, bid);
            pg8::EpiProj E{ws, (const float*)(ws + OFF_ROPE), row0};
            pg8::gemm_phase(lds, g, S, E);
        }
        cg::this_grid().sync();
        attn_phase(p, row0, nrows, lds);
        conv_phase<0>(p, row0, nrows);
        cg::this_grid().sync();
        ssd_phase(p, row0, nrows, lds);
        cg::this_grid().sync();
        combine_phase(p, nrows);
        cg::this_grid().sync();
        {
            pg8::Gemm g{(const bf16_t*)(ws + OFF_ATT), (const bf16_t*)(ws + OFF_WA), nrows, 1024, 256, 256, 256};
            pg8::StaticOrder S; S.init(nrows, 1024, G, bid);
            pg8::EpiSigT E{(float*)(ws + OFF_Z), (const bf16_t*)(ws + OFF_GATES), 0};
            pg8::gemm_phase(lds, g, S, E);
        }
        {
            pg8::Gemm g{(const bf16_t*)(ws + OFF_XBCC), (const bf16_t*)(ws + OFF_WM), nrows, 1024, 2048, LD_XBC, 2048};
            pg8::StaticOrder S; S.init(nrows, 1024, G, bid);
            pg8::EpiMix E{(bf16_t*)(ws + OFF_XS), (const float*)(ws + OFF_Z), (const bf16_t*)(ws + OFF_GATES), 1024};
            pg8::gemm_phase(lds, g, S, E);
        }
        cg::this_grid().sync();
        {
            pg8::Gemm g{(const bf16_t*)(ws + OFF_XS), (const bf16_t*)(ws + OFF_WO), nrows, 1024, 1024, 1024, 1024};
            pg8::StaticOrder S; S.init(nrows, 1024, G, bid);
            pg8::EpiF32 E{(float*)(ws + OFF_QKV), 1024};
            pg8::gemm_phase(lds, g, S, E);
        }
        cg::this_grid().sync();
        post_mix_phase(p, row0, nrows);
        cg::this_grid().sync();
        {
            pg8::Gemm g{(const bf16_t*)(ws + OFF_XS), (const bf16_t*)(ws + OFF_WUP), nrows, 4096, 1024, 1024, 1024};
            pg8::StaticOrder S; S.init(nrows, 4096, G, bid);
            pg8::EpiBf16 E{(bf16_t*)(ws + OFF_Z), 4096};
            pg8::gemm_phase(lds, g, S, E);
        }
        cg::this_grid().sync();
        conv_phase<1>(p, row0, nrows);
        cg::this_grid().sync();
        {
            pg8::Gemm g{(const bf16_t*)(ws + OFF_GATES), (const bf16_t*)(ws + OFF_WDN), nrows, 1024, 2048, 2048, 2048};
            pg8::StaticOrder S; S.init(nrows, 1024, G, bid);
            pg8::EpiF32 E{(float*)(ws + OFF_QKV), 1024};
            pg8::gemm_phase(lds, g, S, E);
        }
        cg::this_grid().sync();
        post_ffn_phase(p, row0, nrows);
        cg::this_grid().sync();
        {
            pg8::Gemm g{(const bf16_t*)(ws + OFF_ATT), (const bf16_t*)(ws + OFF_WP), nrows, 1024, 256, 256, 256};
            pg8::StaticOrder S; S.init(nrows, 1024, G, bid);
            pg8::EpiF32 E{(float*)(ws + OFF_Z), 1024};
            pg8::gemm_phase(lds, g, S, E);
        }
        {
            pg8::Gemm g{(const bf16_t*)(ws + OFF_XS), (const bf16_t*)(ws + OFF_WG), nrows, 1024, 1024, 1024, 1024};
            pg8::StaticOrder S; S.init(nrows, 1024, G, bid);
            pg8::EpiSigMulT E{(float*)(ws + OFF_Z)};
            pg8::gemm_phase(lds, g, S, E);
        }
        cg::this_grid().sync();
        post_ple_phase(p, row0, nrows);
        cg::this_grid().sync();
    }
}
#undef p
#undef ws

extern "C" void kernel_launch(void* const* d_in, const int* in_sizes, int n_in, void* d_out, int out_size, void* d_ws, size_t ws_size, hipStream_t stream) {
    static int grid = 0;
    if (grid == 0) {
        if (n_in != 25 || ws_size < WS_END) { fprintf(stderr, "kernel_launch: unexpected n_in %d / ws %zu (need %zu)\n", n_in, ws_size, (size_t)WS_END); grid = -1; return; }
        int dev = 0, cus = 0, per_cu = 0;
        hipGetDevice(&dev);
        hipDeviceGetAttribute(&cus, hipDeviceAttributeMultiprocessorCount, dev);
        hipFuncSetAttribute((const void*)mega_fwd, hipFuncAttributeMaxDynamicSharedMemorySize, LDS_BYTES);
        hipOccupancyMaxActiveBlocksPerMultiprocessor(&per_cu, (const void*)mega_fwd, NTHR, LDS_BYTES);
        if (per_cu < 1) { fprintf(stderr, "kernel_launch: occupancy query gave %d\n", per_cu); per_cu = 1; }
        grid = cus;
        (void)hipGetLastError();
    }
    if (grid < 0) return;
    Params p{};
    for (int i = 0; i < 25; ++i) p.in[i] = (const float*)d_in[i];
    p.out = (float*)d_out; p.ws = (unsigned char*)d_ws;
    p.npass = 3;
    p.prow0[0] = 0; p.pnrows[0] = 24576;
    p.prow0[1] = 24576; p.pnrows[1] = 28672;
    p.prow0[2] = 53248; p.pnrows[2] = 28672;
    void* args[] = {&p};
    hipError_t e = hipLaunchCooperativeKernel((const void*)mega_fwd, dim3(grid), dim3(NTHR), args, LDS_BYTES, stream);
    if (e != hipSuccess) fprintf(stderr, "kernel_launch: cooperative launch failed: %s (grid %d)\n", hipGetErrorString(e), grid);
}
```
